# Optimizing an MI355X kernel written in HIP

```python
import jax, jax.numpy as jnp
from jax import lax
import numpy as np

D_MODEL = 1024
BATCH = 2
SEQ = 8192
DEPTH = 1

D_MIX = D_MODEL
D_ATTN = D_MIX // 2
D_CONV = D_MIX - D_ATTN
N_HEADS = 8
HEAD_DIM = D_ATTN // N_HEADS
CONV_WIDTH = 3
MOBA_BLOCK = 256
MOBA_TOPK = 3
Q_CHUNK = 64
ROPE_THETA = 10000.0
EPS = 1e-6
NEG = -1e30

kernel_name = "hymba_moba_shortconv_adaln_block"


def rmsnorm(x, g):
    xf = x.astype(jnp.float32)
    y = xf * lax.rsqrt(jnp.mean(xf * xf, axis=-1, keepdims=True) + EPS)
    return (y * g.astype(jnp.float32)).astype(x.dtype)


def rope(t, positions):
    half = HEAD_DIM // 2
    inv_freq = ROPE_THETA ** (-jnp.arange(half, dtype=jnp.float32) / half)
    ang = positions.astype(jnp.float32)[..., None] * inv_freq
    cos = jnp.cos(ang)[:, :, None, :]
    sin = jnp.sin(ang)[:, :, None, :]
    t1 = t[..., :half].astype(jnp.float32)
    t2 = t[..., half:].astype(jnp.float32)
    out = jnp.concatenate([t1 * cos - t2 * sin, t2 * cos + t1 * sin], axis=-1)
    return out.astype(t.dtype)


def moba_attention(q, k, v):
    B, H, S, Dh = q.shape
    nb = -(-S // MOBA_BLOCK)
    s_pad = nb * MOBA_BLOCK
    pad = [(0, 0), (0, 0), (0, s_pad - S), (0, 0)]
    q = jnp.pad(q, pad)
    k = jnp.pad(k, pad)
    v = jnp.pad(v, pad)
    kb = k.reshape(B, H, nb, MOBA_BLOCK, Dh)
    vb = v.reshape(B, H, nb, MOBA_BLOCK, Dh)
    scale = Dh ** -0.5
    n_sel = min(MOBA_TOPK, nb - 1)
    k_mean = jnp.mean(kb.astype(jnp.float32), axis=3)
    n_chunks = s_pad // Q_CHUNK
    q_chunks = q.reshape(B, H, n_chunks, Q_CHUNK, Dh).transpose(2, 0, 1, 3, 4)
    b_ix = jnp.arange(B)[:, None, None]
    h_ix = jnp.arange(H)[None, :, None]
    blk_ids = jnp.arange(nb)

    def chunk(args):
        ci, qc = args
        q_pos = ci * Q_CHUNK + jnp.arange(Q_CHUNK)
        own = (ci * Q_CHUNK) // MOBA_BLOCK
        k_own = lax.dynamic_index_in_dim(kb, own, axis=2, keepdims=False)
        v_own = lax.dynamic_index_in_dim(vb, own, axis=2, keepdims=False)
        k_pos = own * MOBA_BLOCK + jnp.arange(MOBA_BLOCK)
        logit_own = jnp.einsum('bhqd,bhld->bhql', qc, k_own,
                               preferred_element_type=jnp.float32) * scale
        logit_own = jnp.where(k_pos[None, :] <= q_pos[:, None], logit_own, NEG)
        if n_sel == 0:
            p_own = jax.nn.softmax(logit_own, axis=-1).astype(v.dtype)
            return jnp.einsum('bhql,bhld->bhqd', p_own, v_own)
        gate = jnp.einsum('bhqd,bhnd->bhqn', qc.astype(jnp.float32), k_mean)
        gate = jnp.where(blk_ids < own, gate, NEG)
        _, sel = lax.top_k(gate, n_sel)
        valid = sel < own
        sel_flat = sel.reshape(B, H, Q_CHUNK * n_sel)
        k_sel = kb[b_ix, h_ix, sel_flat].reshape(B, H, Q_CHUNK, n_sel, MOBA_BLOCK, Dh)
        v_sel = vb[b_ix, h_ix, sel_flat].reshape(B, H, Q_CHUNK, n_sel, MOBA_BLOCK, Dh)
        logit_past = jnp.einsum('bhqd,bhqnld->bhqnl', qc, k_sel,
                                preferred_element_type=jnp.float32) * scale
        logit_past = jnp.where(valid[..., None], logit_past, NEG)
        logit_past = logit_past.reshape(B, H, Q_CHUNK, n_sel * MOBA_BLOCK)
        logits = jnp.concatenate([logit_past, logit_own], axis=-1)
        p = jax.nn.softmax(logits, axis=-1).astype(v.dtype)
        p_past = p[..., :n_sel * MOBA_BLOCK].reshape(B, H, Q_CHUNK, n_sel, MOBA_BLOCK)
        p_own = p[..., n_sel * MOBA_BLOCK:]
        return (jnp.einsum('bhqnl,bhqnld->bhqd', p_past, v_sel)
                + jnp.einsum('bhql,bhld->bhqd', p_own, v_own))

    out = lax.map(chunk, (jnp.arange(n_chunks), q_chunks))
    out = out.transpose(1, 2, 0, 3, 4).reshape(B, H, s_pad, Dh)
    return out[:, :, :S]


def short_gated_conv(b_gate, c_gate, h, w_conv):
    u = c_gate * h
    y = lax.conv_general_dilated(
        u, w_conv[:, None, :], window_strides=(1,), padding=[(CONV_WIDTH - 1, 0)],
        dimension_numbers=('NWC', 'WIO', 'NWC'), feature_group_count=u.shape[-1])
    return b_gate * y


def setup_inputs(seed: int = 0) -> dict:
    key = jax.random.key(seed)
    ks = jax.random.split(key, 13)
    d_in_cols = 4 * D_ATTN + 4 * D_CONV
    x = jax.random.normal(ks[0], (BATCH, SEQ, D_MODEL), jnp.float32)
    c = jax.random.normal(ks[1], (BATCH, D_MODEL), jnp.float32)
    offsets = jax.random.randint(ks[2], (BATCH, 1), 0, 1024, dtype=jnp.int32)
    positions = jnp.arange(SEQ, dtype=jnp.int32)[None, :] + offsets
    w_ada = jax.random.normal(ks[3], (D_MODEL, 3 * D_MODEL), jnp.float32) * (0.5 * D_MODEL ** -0.5)
    b_ada = 0.01 * jax.random.normal(ks[4], (3 * D_MODEL,), jnp.float32)
    g_norm = 1.0 + 0.02 * jax.random.normal(ks[5], (D_MODEL,), jnp.float32)
    w_in = jax.random.normal(ks[6], (D_MODEL, d_in_cols), jnp.float32) * D_MODEL ** -0.5
    w_conv = jax.random.normal(ks[7], (CONV_WIDTH, D_CONV), jnp.float32) * CONV_WIDTH ** -0.5
    g_attn_out = 1.0 + 0.02 * jax.random.normal(ks[8], (D_ATTN,), jnp.float32)
    g_conv_out = 1.0 + 0.02 * jax.random.normal(ks[9], (D_CONV,), jnp.float32)
    w_out = jax.random.normal(ks[10], (D_MIX, D_MODEL), jnp.float32) * D_MIX ** -0.5
    g_final = 1.0 + 0.02 * jax.random.normal(ks[11], (D_MODEL,), jnp.float32)
    return {"x": x, "c": c, "positions": positions, "w_ada": w_ada, "b_ada": b_ada,
            "g_norm": g_norm, "w_in": w_in, "w_conv": w_conv, "g_attn_out": g_attn_out,
            "g_conv_out": g_conv_out, "w_out": w_out, "g_final": g_final}


def reference(x, c, positions, w_ada, b_ada, g_norm, w_in, w_conv, g_attn_out,
              g_conv_out, w_out, g_final):
    B, S, _ = x.shape
    splits = [D_ATTN, 2 * D_ATTN, 3 * D_ATTN, 4 * D_ATTN,
              4 * D_ATTN + D_CONV, 4 * D_ATTN + 2 * D_CONV, 4 * D_ATTN + 3 * D_CONV]
    for _ in range(DEPTH):
        mod = jax.nn.silu(c) @ w_ada + b_ada
        shift, scale, gate = jnp.split(mod, 3, axis=-1)
        h = rmsnorm(x, g_norm) * (1.0 + scale[:, None, :]) + shift[:, None, :]
        proj = h @ w_in
        q, k, v, z_attn, b_g, c_g, h_c, z_conv = jnp.split(proj, splits, axis=-1)
        q = rope(q.reshape(B, S, N_HEADS, HEAD_DIM), positions).transpose(0, 2, 1, 3)
        k = rope(k.reshape(B, S, N_HEADS, HEAD_DIM), positions).transpose(0, 2, 1, 3)
        v = v.reshape(B, S, N_HEADS, HEAD_DIM).transpose(0, 2, 1, 3)
        y_attn = moba_attention(q, k, v).transpose(0, 2, 1, 3).reshape(B, S, D_ATTN)
        y_attn = rmsnorm(y_attn, g_attn_out) * jax.nn.silu(z_attn)
        y_conv = short_gated_conv(b_g, c_g, h_c, w_conv)
        y_conv = rmsnorm(y_conv, g_conv_out) * jax.nn.silu(z_conv)
        y = jnp.concatenate([y_attn, y_conv], axis=-1) @ w_out
        x = x + gate[:, None, :] * y
    return rmsnorm(x, g_final)
```

```cpp
#include <hip/hip_runtime.h>
#include <stdint.h>

constexpr int NB = 2, SEQ = 8192, DM = 1024, M = NB * SEQ, NIN = 4096, DA = 512, NH = 8, HD = 64, NBLK = 32, BLK = 256;
constexpr float EPS = 1e-6f;
typedef _Float16 f16;
typedef unsigned short bf16_t;

__device__ __forceinline__ bf16_t f2bf(float f) { unsigned u = __float_as_uint(f); return (bf16_t)((u + 0x7fffu + ((u >> 16) & 1u)) >> 16); }
__device__ __forceinline__ float bf2f(bf16_t h) { return __uint_as_float(((unsigned)h) << 16); }
__device__ __forceinline__ float silu_f(float x) { return x / (1.f + expf(-x)); }
__device__ __forceinline__ float wave_sum(float v) {
#pragma unroll
    for (int o = 1; o < 64; o <<= 1) v += __shfl_xor(v, o);
    return v;
}
__device__ __forceinline__ float wave_max(float v) {
#pragma unroll
    for (int o = 1; o < 64; o <<= 1) v = fmaxf(v, __shfl_xor(v, o));
    return v;
}

__constant__ float c_inv_freq[32] = {
    1.000000000e+00f, 7.498942018e-01f, 5.623413324e-01f, 4.216965139e-01f, 3.162277639e-01f, 2.371373773e-01f, 1.778279394e-01f, 1.333521456e-01f,
    1.000000015e-01f, 7.498942316e-02f, 5.623413250e-02f, 4.216964915e-02f, 3.162277490e-02f, 2.371373773e-02f, 1.778279431e-02f, 1.333521400e-02f,
    9.999999776e-03f, 7.498942316e-03f, 5.623413250e-03f, 4.216964822e-03f, 3.162277630e-03f, 2.371373819e-03f, 1.778279431e-03f, 1.333521446e-03f,
    1.000000047e-03f, 7.498941850e-04f, 5.623413017e-04f, 4.216965172e-04f, 3.162277571e-04f, 2.371373703e-04f, 1.778279402e-04f, 1.333521504e-04f};

constexpr size_t MiB = 1u << 20;
constexpr size_t WS_MOD = 1 * MiB;
constexpr size_t WS_KMEAN = 1 * MiB + 256 * 1024;
constexpr size_t WS_KPART = 1 * MiB + 512 * 1024;
constexpr size_t WS_XH = 16 * MiB;
constexpr size_t WS_Q = 48 * MiB;
constexpr size_t WS_K = 64 * MiB;
constexpr size_t WS_V = 80 * MiB;
constexpr size_t WS_ZA = 96 * MiB;
constexpr size_t WS_BG = 112 * MiB;
constexpr size_t WS_CG = 128 * MiB;
constexpr size_t WS_HC = 144 * MiB;
constexpr size_t WS_ZC = 160 * MiB;
constexpr size_t WS_O = 176 * MiB;
constexpr size_t WS_YCAT = 192 * MiB;

__global__ void k_mod(const float* __restrict__ c, const float* __restrict__ w_ada, const float* __restrict__ b_ada, float* __restrict__ mod) {
    const int idx = blockIdx.x * blockDim.x + threadIdx.x;
    if (idx >= NB * 3 * DM) return;
    const int b = idx / (3 * DM), n = idx % (3 * DM);
    float acc = 0.f;
    for (int k = 0; k < DM; ++k) acc += silu_f(c[b * DM + k]) * w_ada[(size_t)k * (3 * DM) + n];
    mod[idx] = acc + b_ada[n];
}

__global__ void k_prep_h(const float* __restrict__ x, const float* __restrict__ g_norm, const float* __restrict__ mod, f16* __restrict__ XH) {
    const int wave = (blockIdx.x * blockDim.x + threadIdx.x) >> 6, lane = threadIdx.x & 63;
    if (wave >= M) return;
    const int m = wave, b = m / SEQ;
    const float* xr = x + (size_t)m * DM;
    float v[16]; float s = 0.f;
#pragma unroll
    for (int j = 0; j < 16; ++j) { v[j] = xr[lane + 64 * j]; s += v[j] * v[j]; }
    s = wave_sum(s);
    const float rstd = rsqrtf(s * (1.f / DM) + EPS);
    const float* shift = mod + b * 3 * DM; const float* scale = shift + DM;
#pragma unroll
    for (int j = 0; j < 16; ++j) { const int k = lane + 64 * j; const float h = (v[j] * rstd * g_norm[k]) * (1.f + scale[k]) + shift[k]; XH[(size_t)m * DM + k] = (f16)h; }
}

__global__ void __launch_bounds__(256) k_gemm1(const f16* __restrict__ XH, const float* __restrict__ w_in, const int* __restrict__ positions,
                                               f16* __restrict__ Q, f16* __restrict__ K, bf16_t* __restrict__ V, bf16_t* __restrict__ ZA,
                                               bf16_t* __restrict__ BG, bf16_t* __restrict__ CG, bf16_t* __restrict__ HC, bf16_t* __restrict__ ZC,
                                               float* __restrict__ KPART) {
    __shared__ float As[16][65];
    __shared__ float Bs[16][65];
    __shared__ float red[16][64];
    const int tid = threadIdx.x, tx = tid & 15, ty = tid >> 4;
    const int m0 = blockIdx.x * 64, n0 = blockIdx.y * 64;
    float acc[4][4];
#pragma unroll
    for (int i = 0; i < 4; ++i)
#pragma unroll
        for (int j = 0; j < 4; ++j) acc[i][j] = 0.f;
    for (int k0 = 0; k0 < DM; k0 += 16) {
#pragma unroll
        for (int e = 0; e < 4; ++e) { const int idx = tid + 256 * e; const int r = idx >> 4, kk = idx & 15; As[kk][r] = (float)XH[(size_t)(m0 + r) * DM + k0 + kk]; }
#pragma unroll
        for (int e = 0; e < 4; ++e) { const int idx = tid + 256 * e; const int kk = idx >> 6, n = idx & 63; Bs[kk][n] = (float)(f16)w_in[(size_t)(k0 + kk) * NIN + n0 + n]; }
        __syncthreads();
#pragma unroll
        for (int kk = 0; kk < 16; ++kk) {
            float a[4], bv[4];
#pragma unroll
            for (int i = 0; i < 4; ++i) a[i] = As[kk][4 * ty + i];
#pragma unroll
            for (int j = 0; j < 4; ++j) bv[j] = Bs[kk][tx + 16 * j];
#pragma unroll
            for (int i = 0; i < 4; ++i)
#pragma unroll
                for (int j = 0; j < 4; ++j) acc[i][j] += a[i] * bv[j];
        }
        __syncthreads();
    }
    const int grp = blockIdx.y >> 3, sub = blockIdx.y & 7;
    const int cbase = sub * 64;
    if (grp == 0 || grp == 1) {
        float ksum[4] = {0.f, 0.f, 0.f, 0.f};
#pragma unroll
        for (int i = 0; i < 4; ++i) {
            const int m = m0 + 4 * ty + i;
            const float pos = (float)positions[m];
#pragma unroll
            for (int p = 0; p < 2; ++p) {
                const int fi = tx + 16 * p;
                const float ang = __fmul_rn(pos, c_inv_freq[fi]);
                const float cs = cosf(ang), sn = sinf(ang);
                const float t1 = acc[i][p], t2 = acc[i][p + 2];
                const float o1 = t1 * cs - t2 * sn, o2 = t2 * cs + t1 * sn;
                f16* dst = (grp == 0 ? Q : K) + (size_t)m * DA + cbase;
                dst[fi] = (f16)o1; dst[fi + 32] = (f16)o2;
                ksum[p] += o1; ksum[p + 2] += o2;
            }
        }
        if (grp == 1) {
#pragma unroll
            for (int j = 0; j < 4; ++j) red[ty][tx + 16 * j] = ksum[j];
            __syncthreads();
            if (tid < 64) { float s = 0.f; for (int r = 0; r < 16; ++r) s += red[r][tid]; KPART[(size_t)blockIdx.x * DA + cbase + tid] = s; }
        }
    } else {
        bf16_t* dst = grp == 2 ? V : grp == 3 ? ZA : grp == 4 ? BG : grp == 5 ? CG : grp == 6 ? HC : ZC;
        const bool act = (grp == 3 || grp == 7);
#pragma unroll
        for (int i = 0; i < 4; ++i) {
            const int m = m0 + 4 * ty + i;
#pragma unroll
            for (int j = 0; j < 4; ++j) { float v = acc[i][j]; if (act) v = silu_f(v); dst[(size_t)m * DA + cbase + tx + 16 * j] = f2bf(v); }
        }
    }
}

__global__ void k_kmean(const float* __restrict__ KPART, float* __restrict__ KMEAN) {
    const int idx = blockIdx.x * blockDim.x + threadIdx.x;
    if (idx >= NB * NBLK * DA) return;
    const int bb = idx / DA, c = idx % DA;
    float s = 0.f;
    for (int p = 0; p < 4; ++p) s += KPART[(size_t)(bb * 4 + p) * DA + c];
    KMEAN[idx] = s * (1.f / BLK);
}

__global__ void __launch_bounds__(256) k_attn(const f16* __restrict__ Q, const f16* __restrict__ K, const bf16_t* __restrict__ V, const float* __restrict__ KMEAN, bf16_t* __restrict__ O) {
    __shared__ float qs[4][64];
    const int lane = threadIdx.x & 63, wib = threadIdx.x >> 6;
    const int wave = blockIdx.x * 4 + wib;
    const int m = wave / NH, h = wave % NH;
    const int b = m / SEQ, t = m % SEQ, own = t / BLK;
    const float qd = (float)Q[(size_t)m * DA + h * HD + lane];
    qs[wib][lane] = qd;
    float mygate = -1e30f;
    for (int j = 0; j < own; ++j) {
        const float g = wave_sum(qd * KMEAN[(size_t)(b * NBLK + j) * DA + h * HD + lane]);
        if (lane == j) mygate = g;
    }
    int sel[3];
#pragma unroll
    for (int s = 0; s < 3; ++s) {
        const float mx = wave_max(mygate);
        if (mx > -1e29f) {
            const unsigned long long bal = __ballot(mygate == mx);
            const int w = __ffsll((long long)bal) - 1;
            sel[s] = w;
            if (lane == w) mygate = -1e30f;
        } else sel[s] = -1;
    }
    __syncthreads();
    float lg[4][4];
    float mx = -1e30f;
#pragma unroll
    for (int s = 0; s < 4; ++s) {
        const int blk = (s < 3) ? sel[s] : own;
#pragma unroll
        for (int i = 0; i < 4; ++i) {
            float l = -1e30f;
            if (blk >= 0) {
                const int kp = blk * BLK + lane + 64 * i;
                if (s < 3 || kp <= t) {
                    const f16* kr = K + (size_t)(b * SEQ + kp) * DA + h * HD;
                    float d = 0.f;
#pragma unroll 8
                    for (int dd = 0; dd < 64; ++dd) d += qs[wib][dd] * (float)kr[dd];
                    l = d * 0.125f;
                }
            }
            lg[s][i] = l; mx = fmaxf(mx, l);
        }
    }
    mx = wave_max(mx);
    float sum = 0.f;
#pragma unroll
    for (int s = 0; s < 4; ++s)
#pragma unroll
        for (int i = 0; i < 4; ++i) { const float p = (lg[s][i] > -1e29f) ? expf(lg[s][i] - mx) : 0.f; lg[s][i] = p; sum += p; }
    sum = wave_sum(sum);
    float acc = 0.f;
#pragma unroll
    for (int s = 0; s < 4; ++s) {
        const int blk = (s < 3) ? sel[s] : own;
        if (blk < 0) continue;
#pragma unroll
        for (int i = 0; i < 4; ++i) {
            const bf16_t* vb = V + (size_t)(b * SEQ + blk * BLK + 64 * i) * DA + h * HD + lane;
            for (int src = 0; src < 64; ++src) {
                const float p = __shfl(lg[s][i], src);
                if (p != 0.f) acc += p * bf2f(vb[(size_t)src * DA]);
            }
        }
    }
    O[(size_t)m * DA + h * HD + lane] = f2bf(acc / sum);
}

__global__ void k_ycat(const bf16_t* __restrict__ O, const bf16_t* __restrict__ ZA, const bf16_t* __restrict__ BG, const bf16_t* __restrict__ CG, const bf16_t* __restrict__ HC,
                       const bf16_t* __restrict__ ZC, const float* __restrict__ w_conv, const float* __restrict__ g_attn, const float* __restrict__ g_conv, bf16_t* __restrict__ YCAT) {
    const int wave = (blockIdx.x * blockDim.x + threadIdx.x) >> 6, lane = threadIdx.x & 63;
    if (wave >= M) return;
    const int m = wave, t = m % SEQ;
    float o[8], yc[8]; float so = 0.f, sc = 0.f;
#pragma unroll
    for (int j = 0; j < 8; ++j) {
        const int c = lane + 64 * j; const size_t ix = (size_t)m * DA + c;
        o[j] = bf2f(O[ix]); so += o[j] * o[j];
        const float u0 = bf2f(CG[ix]) * bf2f(HC[ix]);
        const float u1 = (t >= 1) ? bf2f(CG[ix - DA]) * bf2f(HC[ix - DA]) : 0.f;
        const float u2 = (t >= 2) ? bf2f(CG[ix - 2 * DA]) * bf2f(HC[ix - 2 * DA]) : 0.f;
        const float y = w_conv[c] * u2 + w_conv[DA + c] * u1 + w_conv[2 * DA + c] * u0;
        yc[j] = bf2f(BG[ix]) * y; sc += yc[j] * yc[j];
    }
    so = wave_sum(so); sc = wave_sum(sc);
    const float ro = rsqrtf(so * (1.f / DA) + EPS), rc = rsqrtf(sc * (1.f / DA) + EPS);
#pragma unroll
    for (int j = 0; j < 8; ++j) {
        const int c = lane + 64 * j; const size_t ix = (size_t)m * DA + c;
        YCAT[(size_t)m * DM + c] = f2bf(o[j] * ro * g_attn[c] * bf2f(ZA[ix]));
        YCAT[(size_t)m * DM + DA + c] = f2bf(yc[j] * rc * g_conv[c] * bf2f(ZC[ix]));
    }
}

__global__ void __launch_bounds__(256) k_gemm2(const bf16_t* __restrict__ YCAT, const float* __restrict__ w_out, const float* __restrict__ x, const float* __restrict__ mod,
                                               const float* __restrict__ g_final, float* __restrict__ out) {
    __shared__ float As[8][DM];
    __shared__ float red[8][4];
    const int tid = threadIdx.x, m0 = blockIdx.x * 8, b = m0 / SEQ;
    for (int idx = tid; idx < 8 * DM; idx += 256) As[idx >> 10][idx & 1023] = bf2f(YCAT[(size_t)m0 * DM + idx]);
    __syncthreads();
    float acc[8][4];
#pragma unroll
    for (int r = 0; r < 8; ++r)
#pragma unroll
        for (int j = 0; j < 4; ++j) acc[r][j] = 0.f;
    for (int k = 0; k < DM; ++k) {
        float w[4];
#pragma unroll
        for (int j = 0; j < 4; ++j) w[j] = bf2f(f2bf(w_out[(size_t)k * DM + tid + 256 * j]));
#pragma unroll
        for (int r = 0; r < 8; ++r) { const float a = As[r][k];
#pragma unroll
            for (int j = 0; j < 4; ++j) acc[r][j] += a * w[j]; }
    }
    const float* gate = mod + b * 3 * DM + 2 * DM;
    const int lane = tid & 63, wib = tid >> 6;
#pragma unroll
    for (int r = 0; r < 8; ++r) {
        float s = 0.f;
#pragma unroll
        for (int j = 0; j < 4; ++j) { const int n = tid + 256 * j; const float v = x[(size_t)(m0 + r) * DM + n] + gate[n] * acc[r][j]; acc[r][j] = v; s += v * v; }
        s = wave_sum(s);
        if (lane == 0) red[r][wib] = s;
    }
    __syncthreads();
#pragma unroll
    for (int r = 0; r < 8; ++r) {
        const float s = (red[r][0] + red[r][1]) + (red[r][2] + red[r][3]);
        const float rstd = rsqrtf(s * (1.f / DM) + EPS);
#pragma unroll
        for (int j = 0; j < 4; ++j) { const int n = tid + 256 * j; out[(size_t)(m0 + r) * DM + n] = acc[r][j] * rstd * g_final[n]; }
    }
}

extern "C" void kernel_launch(void* const* d_in, const int* in_sizes, int n_in, void* d_out, int out_size, void* d_ws, size_t ws_size, hipStream_t stream) {
    const float* x = (const float*)d_in[0]; const float* c = (const float*)d_in[1]; const int* positions = (const int*)d_in[2];
    const float* w_ada = (const float*)d_in[3]; const float* b_ada = (const float*)d_in[4]; const float* g_norm = (const float*)d_in[5];
    const float* w_in = (const float*)d_in[6]; const float* w_conv = (const float*)d_in[7]; const float* g_attn = (const float*)d_in[8];
    const float* g_conv = (const float*)d_in[9]; const float* w_out = (const float*)d_in[10]; const float* g_final = (const float*)d_in[11];
    unsigned char* ws = (unsigned char*)d_ws;
    float* mod = (float*)(ws + WS_MOD); float* KMEAN = (float*)(ws + WS_KMEAN); float* KPART = (float*)(ws + WS_KPART);
    f16* XH = (f16*)(ws + WS_XH); f16* Q = (f16*)(ws + WS_Q); f16* K = (f16*)(ws + WS_K);
    bf16_t* V = (bf16_t*)(ws + WS_V); bf16_t* ZA = (bf16_t*)(ws + WS_ZA); bf16_t* BG = (bf16_t*)(ws + WS_BG); bf16_t* CG = (bf16_t*)(ws + WS_CG);
    bf16_t* HC = (bf16_t*)(ws + WS_HC); bf16_t* ZC = (bf16_t*)(ws + WS_ZC); bf16_t* O = (bf16_t*)(ws + WS_O); bf16_t* YCAT = (bf16_t*)(ws + WS_YCAT);
    float* out = (float*)d_out;
    k_mod<<<(NB * 3 * DM + 255) / 256, 256, 0, stream>>>(c, w_ada, b_ada, mod);
    k_prep_h<<<M / 4, 256, 0, stream>>>(x, g_norm, mod, XH);
    k_gemm1<<<dim3(M / 64, NIN / 64), 256, 0, stream>>>(XH, w_in, positions, Q, K, V, ZA, BG, CG, HC, ZC, KPART);
    k_kmean<<<(NB * NBLK * DA + 255) / 256, 256, 0, stream>>>(KPART, KMEAN);
    k_attn<<<M * NH / 4, 256, 0, stream>>>(Q, K, V, KMEAN, O);
    k_ycat<<<M / 4, 256, 0, stream>>>(O, ZA, BG, CG, HC, ZC, w_conv, g_attn, g_conv, YCAT);
    k_gemm2<<<M / 8, 256, 0, stream>>>(YCAT, w_out, x, mod, g_final, out);
}
```
